# Optimizing an MI355X kernel written in HIP

```python
import jax, jax.numpy as jnp
from jax import lax
import numpy as np

D_MODEL = 1024
BATCH = 8
SEQ = 2048
DEPTH = 2

N_META = 16
D_MIX = D_MODEL
POOL_WIDTH = D_MIX // 4
POOL_WINDOWS = (2, 4, 8, 16)
POOL_GROUP = POOL_WIDTH // len(POOL_WINDOWS)
CONV_WIDTH = D_MIX // 4
CONV_K = 3
GLA_WIDTH = D_MIX // 2
GLA_HEADS = 4
GLA_DV = GLA_WIDTH // GLA_HEADS
GLA_DK = GLA_DV // 2
GLA_KW = GLA_HEADS * GLA_DK
GLA_GATE_RANK = 16
GLA_TAU = 16.0
GLA_CHUNK = 64
D_FF = 2816
FFN_RESID = 0.5
EPS = 1e-6
PROJ_SIZES = (POOL_WIDTH, CONV_WIDTH, CONV_WIDTH, CONV_WIDTH, GLA_KW, GLA_KW, GLA_WIDTH, GLA_GATE_RANK, GLA_WIDTH)
D_PROJ = sum(PROJ_SIZES)

kernel_name = 'hymba_pool_conv_gla_macaron_block'


def rms_norm(x, g):
    xf = x.astype(jnp.float32)
    y = xf * lax.rsqrt(jnp.mean(xf * xf, axis=-1, keepdims=True) + EPS)
    return (y * g.astype(jnp.float32)).astype(x.dtype)


def swiglu(h, w_gate, w_up, w_down):
    return (jax.nn.silu(h @ w_gate) * (h @ w_up)) @ w_down


def pool_mixer(p, w_group, scale):
    B, L, _ = p.shape
    pg = p.reshape(B, L, len(POOL_WINDOWS), POOL_GROUP).astype(jnp.float32)
    csum = jnp.cumsum(pg, axis=1)
    pos = jnp.arange(1, L + 1, dtype=jnp.float32)
    outs = []
    for i, w in enumerate(POOL_WINDOWS):
        ci = csum[:, :, i]
        prev = jnp.pad(ci, ((0, 0), (w, 0), (0, 0)))[:, :L]
        cnt = jnp.minimum(pos, float(w))[None, :, None]
        outs.append((ci - prev) / cnt - pg[:, :, i])
    m = jnp.stack(outs, axis=2).astype(p.dtype)
    y = jnp.einsum('blgc,gcd->blgd', m, w_group)
    return y.reshape(B, L, POOL_WIDTH) * scale


def conv_mixer(gate_b, gate_c, u, w_conv):
    z = gate_c * u
    y = lax.conv_general_dilated(
        z, w_conv[:, None, :].astype(z.dtype), window_strides=(1,),
        padding=[(CONV_K - 1, 0)], dimension_numbers=('NWC', 'WIO', 'NWC'),
        feature_group_count=CONV_WIDTH)
    return gate_b * y


def gla_mixer(q, k, v, g_low, out_gate, w_g2, b_g2, norm_g):
    B, L, _ = q.shape
    out_dtype = q.dtype
    f32 = jnp.float32
    log_a = jax.nn.log_sigmoid((g_low @ w_g2 + b_g2).astype(f32)) / GLA_TAU
    pad_front = (-N_META) % GLA_CHUNK
    Lp = L + pad_front
    n_chunks = Lp // GLA_CHUNK

    def to_chunks(t, d):
        t = jnp.pad(t.astype(f32), ((0, 0), (pad_front, 0), (0, 0)))
        t = t.reshape(B, n_chunks, GLA_CHUNK, GLA_HEADS, d)
        return t.transpose(1, 0, 3, 2, 4)

    qc = to_chunks(q, GLA_DK) * (GLA_DK ** -0.5)
    kc = to_chunks(k, GLA_DK)
    vc = to_chunks(v, GLA_DV)
    gc = to_chunks(log_a, GLA_DK)
    causal = jnp.tril(jnp.ones((GLA_CHUNK, GLA_CHUNK), dtype=bool))

    def step(S, inp):
        qi, ki, vi, gi = inp
        b = jnp.cumsum(gi, axis=2)
        inter = jnp.einsum('bhtd,bhde->bhte', qi * jnp.exp(b), S)
        diff = b[:, :, :, None, :] - b[:, :, None, :, :]
        decay = jnp.exp(jnp.where(causal[:, :, None], diff, -jnp.inf))
        scores = jnp.einsum('bhtd,bhsd,bhtsd->bhts', qi, ki, decay)
        intra = jnp.einsum('bhts,bhse->bhte', scores, vi)
        b_last = b[:, :, -1:, :]
        S = S * jnp.exp(b_last[:, :, 0, :])[..., None] + jnp.einsum(
            'bhsd,bhse->bhde', ki * jnp.exp(b_last - b), vi)
        return S, inter + intra

    S0 = jnp.zeros((B, GLA_HEADS, GLA_DK, GLA_DV), f32)
    _, o = lax.scan(step, S0, (qc, kc, vc, gc))
    o = o.transpose(1, 0, 3, 2, 4).reshape(B, Lp, GLA_HEADS, GLA_DV)[:, pad_front:]
    o = o * lax.rsqrt(jnp.mean(o * o, axis=-1, keepdims=True) + EPS)
    o = o * norm_g.reshape(GLA_HEADS, GLA_DV).astype(f32)
    o = o.reshape(B, L, GLA_WIDTH) * jax.nn.silu(out_gate.astype(f32))
    return o.astype(out_dtype)


def setup_inputs(seed: int = 0) -> dict:
    key = jax.random.key(seed)
    ks = jax.random.split(key, 22)
    f32 = jnp.float32
    nrm = lambda k, shape, s: jax.random.normal(k, shape, f32) * s
    gain = lambda k, shape: 1.0 + 0.02 * jax.random.normal(k, shape, f32)
    return {
        'x': nrm(ks[0], (BATCH, SEQ, D_MODEL), 1.0),
        'meta': nrm(ks[1], (N_META, D_MODEL), 1.0),
        'ffn1_pre': gain(ks[2], (DEPTH, D_MODEL)),
        'ffn1_post': gain(ks[3], (DEPTH, D_MODEL)),
        'ffn1_wg': nrm(ks[4], (DEPTH, D_MODEL, D_FF), D_MODEL ** -0.5),
        'ffn1_wu': nrm(ks[5], (DEPTH, D_MODEL, D_FF), D_MODEL ** -0.5),
        'ffn1_wd': nrm(ks[6], (DEPTH, D_FF, D_MODEL), D_FF ** -0.5),
        'mix_pre': gain(ks[7], (DEPTH, D_MODEL)),
        'mix_post': gain(ks[8], (DEPTH, D_MODEL)),
        'w_in': nrm(ks[9], (DEPTH, D_MODEL, D_PROJ), D_MODEL ** -0.5),
        'pool_w': nrm(ks[10], (DEPTH, len(POOL_WINDOWS), POOL_GROUP, POOL_GROUP), POOL_GROUP ** -0.5),
        'pool_scale': gain(ks[11], (DEPTH, POOL_WIDTH)),
        'conv_w': nrm(ks[12], (DEPTH, CONV_K, CONV_WIDTH), CONV_K ** -0.5),
        'gla_w2': nrm(ks[13], (DEPTH, GLA_GATE_RANK, GLA_KW), GLA_GATE_RANK ** -0.5),
        'gla_b2': nrm(ks[14], (DEPTH, GLA_KW), 0.01),
        'gla_norm': gain(ks[15], (DEPTH, GLA_WIDTH)),
        'w_out': nrm(ks[16], (DEPTH, D_MIX, D_MODEL), D_MIX ** -0.5),
        'ffn2_pre': gain(ks[17], (DEPTH, D_MODEL)),
        'ffn2_post': gain(ks[18], (DEPTH, D_MODEL)),
        'ffn2_wg': nrm(ks[19], (DEPTH, D_MODEL, D_FF), D_MODEL ** -0.5),
        'ffn2_wu': nrm(ks[20], (DEPTH, D_MODEL, D_FF), D_MODEL ** -0.5),
        'ffn2_wd': nrm(ks[21], (DEPTH, D_FF, D_MODEL), D_FF ** -0.5),
    }


def reference(x, meta, ffn1_pre, ffn1_post, ffn1_wg, ffn1_wu, ffn1_wd,
              mix_pre, mix_post, w_in, pool_w, pool_scale, conv_w,
              gla_w2, gla_b2, gla_norm, w_out,
              ffn2_pre, ffn2_post, ffn2_wg, ffn2_wu, ffn2_wd):
    B = x.shape[0]
    h = jnp.concatenate(
        [jnp.broadcast_to(meta.astype(x.dtype)[None], (B, N_META, D_MODEL)), x], axis=1)
    split_idx = np.cumsum(PROJ_SIZES)[:-1].tolist()
    for l in range(DEPTH):
        f = swiglu(rms_norm(h, ffn1_pre[l]), ffn1_wg[l], ffn1_wu[l], ffn1_wd[l])
        h = h + FFN_RESID * rms_norm(f, ffn1_post[l])
        a = rms_norm(h, mix_pre[l])
        proj = a @ w_in[l]
        p_pool, c_b, c_c, c_u, g_q, g_k, g_v, g_low, g_out = jnp.split(proj, split_idx, axis=-1)
        y_pool = pool_mixer(p_pool, pool_w[l], pool_scale[l])
        y_conv = conv_mixer(c_b, c_c, c_u, conv_w[l])
        y_gla = gla_mixer(g_q, g_k, g_v, g_low, g_out, gla_w2[l], gla_b2[l], gla_norm[l])
        mix = jnp.concatenate([y_pool, y_conv, y_gla], axis=-1) @ w_out[l]
        h = h + rms_norm(mix, mix_post[l])
        f = swiglu(rms_norm(h, ffn2_pre[l]), ffn2_wg[l], ffn2_wu[l], ffn2_wd[l])
        h = h + FFN_RESID * rms_norm(f, ffn2_post[l])
    return h[:, N_META:]
```

```cpp
#include <hip/hip_runtime.h>
#include <cstdio>
#include <cstdint>
namespace pg8 {
#define PG8_LAS __attribute__((address_space(3)))
typedef unsigned short bf16_t;
typedef short bf16x8 __attribute__((ext_vector_type(8)));
typedef float f32x4 __attribute__((ext_vector_type(4)));
typedef unsigned u32x4 __attribute__((ext_vector_type(4)));
constexpr int BM = 256, BK = 64, HALF = 128, HTB = HALF * BK * 2  , STAGE_BYTES = 8 * HTB, NXCD = 8, WGM = 8;

__host__ __device__ __forceinline__ int lds_byte(int r, int c) { const int st = (r >> 4) * 2 + (c >> 5), rr = r & 15, cc = c & 31, ob = rr * 64 + cc * 2; return st * 1024 + (ob ^ (((ob >> 9) & 1) << 5)); }
__host__ __device__ __forceinline__ void stage_rc(int b, int& R, int& C) { const int st = b / 1024, sb = b % 1024, swz = sb ^ (((sb >> 9) & 1) << 5); R = (st >> 1) * 16 + swz / 64; C = (st & 1) * 32 + (swz % 64) / 2; }
__host__ __device__ __forceinline__ int perm32(int rho) { const int n = rho >> 4, i = rho & 15; return 8 * (i >> 2) + 4 * n + (i & 3); }

struct Unit { int pm, pn; };
struct Gemm { const bf16_t* A; const bf16_t* Bt; int M, N, K, pad; };

struct StaticOrder {
    int nM, nN, nwg, G, c;
    __host__ __device__ void init(int M, int N, int G_, int c_) { nM = M / BM; nN = N / BM; nwg = nM * nN; G = G_; c = c_; }
    __host__ __device__ bool next(int i, Unit& u) const {
        const long L = (long)i * G + c; if (L >= nwg) return false;
        int wgid = (int)L; { const int q = nwg / NXCD, r = nwg % NXCD, xcd = wgid % NXCD, off = wgid / NXCD; wgid = (xcd < r ? xcd * (q + 1) : r * (q + 1) + (xcd - r) * q) + off; }
        const int nig = WGM * nN, gid = wgid / nig, fm = gid * WGM, gsz = (nM - fm) < WGM ? (nM - fm) : WGM;
        u.pm = fm + ((wgid % nig) % gsz); u.pn = (wgid % nig) / gsz; return true;
    }
    __device__ __forceinline__ void a_ready(const Unit&) const {}
    __device__ __forceinline__ void done(const Unit&) const {}
};

__device__ __forceinline__ unsigned cvt_pk_bf16(float lo, float hi) { unsigned r; asm volatile("v_cvt_pk_bf16_f32 %0, %1, %2" : "=v"(r) : "v"(lo), "v"(hi)); return r; }
typedef unsigned u32x2 __attribute__((ext_vector_type(2)));
__device__ __forceinline__ float silu_f(float x) { return x * __builtin_amdgcn_rcpf(1.0f + __builtin_amdgcn_exp2f(-1.44269504089f * x)); }
struct EpiBf16 {
    static constexpr bool PERM = true, AFTER_DRAIN = false;
    bf16_t* O; int ldc; int pad;
    __device__ __forceinline__ void operator()(const f32x4 (&acc)[2][2][4][2], const Unit& u, int wr, int wc, int fr, int fq) const {
        const int row0 = u.pm * BM + wr * 64 + fr; const int col0 = u.pn * BM + wc * 32 + 8 * fq;
#pragma unroll
        for (int ai = 0; ai < 2; ++ai)
#pragma unroll
            for (int m = 0; m < 4; ++m) { bf16_t* rowp = O + (size_t)(row0 + ai * HALF + m * 16) * ldc + col0;
#pragma unroll
                for (int bj = 0; bj < 2; ++bj) { const f32x4 v0 = acc[ai][bj][m][0], v1 = acc[ai][bj][m][1];
                    u32x4 w; w.x = cvt_pk_bf16(v0[0], v0[1]); w.y = cvt_pk_bf16(v0[2], v0[3]); w.z = cvt_pk_bf16(v1[0], v1[1]); w.w = cvt_pk_bf16(v1[2], v1[3]);
                    *(u32x4*)(rowp + bj * HALF) = w; } }
    }
};
struct EpiSwiGLU {
    static constexpr bool PERM = true, AFTER_DRAIN = false;
    bf16_t* O; int ldc; int pad;
    __device__ __forceinline__ void operator()(const f32x4 (&acc)[2][2][4][2], const Unit& u, int wr, int wc, int fr, int fq) const {
        const int row0 = u.pm * BM + wr * 64 + fr; const int col0 = u.pn * HALF + wc * 32 + 8 * fq;
#pragma unroll
        for (int ai = 0; ai < 2; ++ai)
#pragma unroll
            for (int m = 0; m < 4; ++m) { bf16_t* rowp = O + (size_t)(row0 + ai * HALF + m * 16) * ldc + col0;
                const f32x4 g0 = acc[ai][0][m][0], g1 = acc[ai][0][m][1], u0 = acc[ai][1][m][0], u1 = acc[ai][1][m][1];
                u32x4 w; w.x = cvt_pk_bf16(silu_f(g0[0]) * u0[0], silu_f(g0[1]) * u0[1]); w.y = cvt_pk_bf16(silu_f(g0[2]) * u0[2], silu_f(g0[3]) * u0[3]);
                w.z = cvt_pk_bf16(silu_f(g1[0]) * u1[0], silu_f(g1[1]) * u1[1]); w.w = cvt_pk_bf16(silu_f(g1[2]) * u1[2], silu_f(g1[3]) * u1[3]);
                *(u32x4*)rowp = w; }
    }
};
struct EpiF32S {
    static constexpr bool PERM = false, AFTER_DRAIN = false;
    float* C_lo; float* C_hi; int ldc; int split_row;
    __device__ __forceinline__ void operator()(const f32x4 (&acc)[2][2][4][2], const Unit& u, int wr, int wc, int fr, int fq) const {
        const int row0 = u.pm * BM + wr * 64 + fr, col0 = u.pn * BM + wc * 32 + 4 * fq;
        float* base = (u.pm * BM < split_row) ? C_lo + (size_t)row0 * ldc : C_hi + (size_t)(row0 - split_row) * ldc;
#pragma unroll
        for (int ai = 0; ai < 2; ++ai)
#pragma unroll
            for (int m = 0; m < 4; ++m) { float* rowp = base + (size_t)(ai * HALF + m * 16) * ldc + col0;
#pragma unroll
                for (int bj = 0; bj < 2; ++bj)
#pragma unroll
                    for (int n = 0; n < 2; ++n) *(f32x4*)(rowp + bj * HALF + n * 16) = acc[ai][bj][m][n]; }
    }
};
template <class Epi, class Sched, bool ALIGN_EPI = false, bool SP2 = false>
__device__ __forceinline__ void gemm_phase(PG8_LAS unsigned char* lds, const Gemm g, const Sched& S, const Epi& E) {
    const int tid = threadIdx.x, wid = __builtin_amdgcn_readfirstlane(tid >> 6), lane = tid & 63, wr = wid >> 2, wc = wid & 3, fr = lane & 15, fq = lane >> 4;
    const int K = g.K, nt = K / BK;
    unsigned voffA[2], voffB[2];
#pragma unroll
    for (int i = 0; i < 2; ++i) { int R, C; stage_rc(tid * 16 + i * 8192, R, C); const int Rb = Epi::PERM ? ((R & ~31) + perm32(R & 31)) : R;
        voffA[i] = (unsigned)(R * K + C) * 2u; voffB[i] = (unsigned)(Rb * K + C) * 2u; }
    const size_t kstep = (size_t)(BK * 2);
    const size_t hstep = (size_t)HALF * K * 2;
    const size_t tstep = 2 * hstep;
    const unsigned ldsw = (unsigned)wid * 1024u;
    const int aoff = lds_byte(wr * 64 + fr, fq * 8), boff = lds_byte(wc * 32 + fr, fq * 8);
#define PG8_SA(b, h) (((b) * 2 + (h)) * HTB)
#define PG8_SB(b, h) ((4 + (b) * 2 + (h)) * HTB)
#define PG8_STAGE(bufoff, gbase, voff) do { _Pragma("unroll") for (int _i = 0; _i < 2; ++_i) \
        __builtin_amdgcn_global_load_lds((const unsigned*)((const char*)(gbase) + (voff)[_i]), (PG8_LAS unsigned*)(lds + (bufoff) + ldsw + _i * 8192), 16, 0, 0); } while (0)
#define PG8_LDA(dst, b, h) do { _Pragma("unroll") for (int m = 0; m < 4; ++m) _Pragma("unroll") for (int k = 0; k < 2; ++k) dst[m][k] = *(const PG8_LAS bf16x8*)(lds + PG8_SA(b, h) + aoff + m * 2048 + k * 1024); } while (0)
#define PG8_LDB(dst, b, h) do { _Pragma("unroll") for (int n = 0; n < 2; ++n) _Pragma("unroll") for (int k = 0; k < 2; ++k) dst[n][k] = *(const PG8_LAS bf16x8*)(lds + PG8_SB(b, h) + boff + n * 2048 + k * 1024); } while (0)
#define PG8_MMA(ai, bj, At, Bt) do { __builtin_amdgcn_s_setprio(1); _Pragma("unroll") for (int m = 0; m < 4; ++m) _Pragma("unroll") for (int n = 0; n < 2; ++n) _Pragma("unroll") for (int k = 0; k < 2; ++k) \
        acc[ai][bj][m][n] = __builtin_amdgcn_mfma_f32_16x16x32_bf16(Bt[n][k], At[m][k], acc[ai][bj][m][n], 0, 0, 0); __builtin_amdgcn_s_setprio(0); } while (0)
#define PG8_WAIT_V(n) asm volatile("s_waitcnt vmcnt(" #n ")" ::: "memory")
#define PG8_WAIT_L(n) asm volatile("s_waitcnt lgkmcnt(" #n ")" ::: "memory")
#define PG8_BAR __builtin_amdgcn_s_barrier()
#define PG8_SCHED __builtin_amdgcn_sched_barrier(0)
    Unit cur, nxt; int ui = 0;
    if (!S.next(0, cur)) return;
    f32x4 acc[2][2][4][2];
#pragma unroll
    for (int a = 0; a < 2; ++a)
#pragma unroll
        for (int b = 0; b < 2; ++b)
#pragma unroll
            for (int m = 0; m < 4; ++m)
#pragma unroll
                for (int n = 0; n < 2; ++n) acc[a][b][m][n] = (f32x4){0.f, 0.f, 0.f, 0.f};
    bf16x8 At[4][2], B0[2][2], B1[2][2];
    const char* cA = (const char*)g.A + (size_t)cur.pm * tstep; const char* cB = (const char*)g.Bt + (size_t)cur.pn * tstep;
    S.a_ready(cur);
    if constexpr (SP2) {
        PG8_STAGE(PG8_SB(0, 0), cB, voffB); PG8_STAGE(PG8_SB(0, 1), cB + hstep, voffB); PG8_STAGE(PG8_SA(0, 0), cA, voffA); PG8_STAGE(PG8_SA(0, 1), cA + hstep, voffA);
        if (wr == 1) PG8_BAR;
        PG8_WAIT_V(2); PG8_BAR;
        PG8_STAGE(PG8_SB(1, 0), cB + kstep, voffB); PG8_STAGE(PG8_SA(1, 0), cA + kstep, voffA); PG8_STAGE(PG8_SB(1, 1), cB + hstep + kstep, voffB);
        PG8_WAIT_V(6); PG8_BAR;
    } else {
        PG8_STAGE(PG8_SB(0, 0), cB, voffB); PG8_STAGE(PG8_SA(0, 0), cA, voffA); PG8_STAGE(PG8_SB(0, 1), cB + hstep, voffB); PG8_STAGE(PG8_SA(0, 1), cA + hstep, voffA);
        if (wr == 1) PG8_BAR;
        PG8_WAIT_V(4); PG8_BAR;
        PG8_STAGE(PG8_SB(1, 0), cB + kstep, voffB); PG8_STAGE(PG8_SA(1, 0), cA + kstep, voffA); PG8_STAGE(PG8_SB(1, 1), cB + hstep + kstep, voffB);
        PG8_WAIT_V(6); PG8_BAR;
    }
    for (;;) {
        const bool has_next = S.next(ui + 1, nxt);
        const char* nA = has_next ? (const char*)g.A + (size_t)nxt.pm * tstep : cA; const char* nB = has_next ? (const char*)g.Bt + (size_t)nxt.pn * tstep : cB;
        for (int t = 0; t < nt; t += 2) {
            const bool last = (t == nt - 2);
            const char* a1 = cA + (size_t)(t + 1) * kstep;
            const char* a2 = last ? nA : cA + (size_t)(t + 2) * kstep; const char* b2 = last ? nB : cB + (size_t)(t + 2) * kstep;
            const char* a3 = a2 + kstep; const char* b3 = b2 + kstep;
            if (last && has_next) S.a_ready(nxt);
            if constexpr (SP2) {
            PG8_LDB(B0, 0, 0); PG8_LDB(B1, 0, 1); PG8_SCHED; PG8_LDA(At, 0, 0); PG8_STAGE(PG8_SA(1, 1), a1 + hstep, voffA);
            PG8_WAIT_V(8); PG8_WAIT_L(0); PG8_BAR; PG8_MMA(0, 0, At, B0); PG8_MMA(0, 1, At, B1); PG8_BAR; PG8_SCHED;
            PG8_LDA(At, 0, 1); PG8_STAGE(PG8_SB(0, 0), b2, voffB); PG8_STAGE(PG8_SB(0, 1), b2 + hstep, voffB); PG8_STAGE(PG8_SA(0, 0), a2, voffA);
            PG8_WAIT_V(8); PG8_WAIT_L(0); PG8_BAR; PG8_MMA(1, 0, At, B0); PG8_MMA(1, 1, At, B1); PG8_BAR; PG8_SCHED;
            PG8_LDB(B0, 1, 0); PG8_LDB(B1, 1, 1); PG8_SCHED; PG8_LDA(At, 1, 0); PG8_STAGE(PG8_SA(0, 1), a2 + hstep, voffA);
            PG8_WAIT_V(8); PG8_WAIT_L(0); PG8_BAR; PG8_MMA(0, 0, At, B0); PG8_MMA(0, 1, At, B1); PG8_BAR; PG8_SCHED;
            PG8_LDA(At, 1, 1); PG8_STAGE(PG8_SB(1, 0), b3, voffB); PG8_STAGE(PG8_SB(1, 1), b3 + hstep, voffB); PG8_STAGE(PG8_SA(1, 0), a3, voffA);
            PG8_WAIT_V(8); PG8_WAIT_L(0); PG8_BAR; PG8_MMA(1, 0, At, B0); PG8_MMA(1, 1, At, B1); PG8_BAR; PG8_SCHED;
            } else {
            PG8_LDB(B0, 0, 0); PG8_SCHED; PG8_LDA(At, 0, 0); PG8_STAGE(PG8_SA(1, 1), a1 + hstep, voffA);
            PG8_WAIT_L(8); PG8_BAR; PG8_WAIT_L(0); PG8_MMA(0, 0, At, B0); PG8_BAR; PG8_SCHED;
            PG8_LDB(B1, 0, 1); PG8_STAGE(PG8_SB(0, 0), b2, voffB);
            PG8_BAR; PG8_WAIT_L(0); PG8_MMA(0, 1, At, B1); PG8_BAR;
            PG8_LDA(At, 0, 1); PG8_STAGE(PG8_SA(0, 0), a2, voffA);
            PG8_BAR; PG8_WAIT_L(0); PG8_MMA(1, 0, At, B0); PG8_BAR; PG8_SCHED;
            PG8_STAGE(PG8_SB(0, 1), b2 + hstep, voffB);
            PG8_WAIT_V(6); PG8_BAR; PG8_MMA(1, 1, At, B1); PG8_BAR;
            PG8_LDB(B0, 1, 0); PG8_SCHED; PG8_LDA(At, 1, 0); PG8_STAGE(PG8_SA(0, 1), a2 + hstep, voffA);
            PG8_WAIT_L(8); PG8_BAR; PG8_WAIT_L(0); PG8_MMA(0, 0, At, B0); PG8_BAR; PG8_SCHED;
            PG8_LDB(B1, 1, 1); PG8_STAGE(PG8_SB(1, 0), b3, voffB);
            PG8_BAR; PG8_WAIT_L(0); PG8_MMA(0, 1, At, B1); PG8_BAR;
            PG8_LDA(At, 1, 1); PG8_STAGE(PG8_SA(1, 0), a3, voffA);
            PG8_BAR; PG8_WAIT_L(0); PG8_MMA(1, 0, At, B0); PG8_BAR; PG8_SCHED;
            PG8_STAGE(PG8_SB(1, 1), b3 + hstep, voffB);
            PG8_WAIT_V(6); PG8_BAR; PG8_MMA(1, 1, At, B1); PG8_BAR;
            }
        }
        if constexpr (ALIGN_EPI) { if (wr == 0) PG8_BAR; }
        if constexpr (!Epi::AFTER_DRAIN) { E(acc, cur, wr, wc, fr, fq); S.done(cur); }
        if (!has_next) break;
#pragma unroll
        for (int a = 0; a < 2; ++a)
#pragma unroll
            for (int b = 0; b < 2; ++b)
#pragma unroll
                for (int m = 0; m < 4; ++m)
#pragma unroll
                    for (int n = 0; n < 2; ++n) acc[a][b][m][n] = (f32x4){0.f, 0.f, 0.f, 0.f};
        cur = nxt; cA = nA; cB = nB; ++ui;
        if constexpr (ALIGN_EPI) { if (wr == 1) PG8_BAR; }
    }
    PG8_WAIT_V(0);
    if constexpr (!ALIGN_EPI) { if (wr == 0) PG8_BAR; }
    PG8_BAR;
    if constexpr (Epi::AFTER_DRAIN) { E.fused(acc, cur, wr, wc, fr, fq, lds, wid, lane); S.done(cur); }
#undef PG8_SA
#undef PG8_SB
#undef PG8_STAGE
#undef PG8_LDA
#undef PG8_LDB
#undef PG8_MMA
#undef PG8_WAIT_V
#undef PG8_WAIT_L
#undef PG8_BAR
#undef PG8_SCHED
}
}
constexpr int BATCH = 8, SEQ = 2048, NMETA = 16, LTOK = SEQ + NMETA, D = 1024, DFF = 2816, DEPTH = 2;
constexpr int MROWS = BATCH * LTOK;
constexpr int MPAD = 16640;
constexpr int NGU = 2 * DFF;
constexpr int NPROJ = 2816;
constexpr int DPROJ_SRC = 2576;
constexpr float EPS = 1e-6f;
constexpr int PC_POOL = 0, PC_CB = 256, PC_CC = 512, PC_CU = 768, PC_Q = 1024, PC_K = 1280, PC_V = 1536, PC_GX = 2048, PC_GO = 2304;
#define GAS __attribute__((address_space(1)))
#define LAS __attribute__((address_space(3)))
typedef unsigned short bf16;
typedef unsigned v4u __attribute__((ext_vector_type(4)));
typedef float f32x4 __attribute__((ext_vector_type(4)));
__device__ __forceinline__ unsigned f2bf(float f) { unsigned u = __builtin_bit_cast(unsigned, f); return (u + 0x7fffu + ((u >> 16) & 1u)) >> 16; }
__device__ __forceinline__ unsigned pk2(float lo, float hi) { return f2bf(lo) | (f2bf(hi) << 16); }
__device__ __forceinline__ float bf2f(bf16 b) { return __builtin_bit_cast(float, ((unsigned)b) << 16); }
__device__ __forceinline__ float wave_sum(float v) {
#pragma unroll
    for (int o = 1; o < 64; o <<= 1) v += __shfl_xor(v, o);
    return v;
}
constexpr size_t MiB = 1u << 20;
constexpr size_t SZ_WGU = (size_t)NGU * D * 2, SZ_WD = (size_t)D * DFF * 2, SZ_WIN = (size_t)NPROJ * D * 2, SZ_WOUT = (size_t)D * D * 2;
constexpr size_t WS_WGU1 = 0, WS_WD1 = WS_WGU1 + SZ_WGU, WS_WIN = WS_WD1 + SZ_WD, WS_WOUT = WS_WIN + SZ_WIN, WS_WGU2 = WS_WOUT + SZ_WOUT, WS_WD2 = WS_WGU2 + SZ_WGU, WS_WEND = WS_WD2 + SZ_WD;
static_assert(WS_WEND <= 41 * MiB, "weights");
constexpr size_t WS_H = 41 * MiB;
constexpr size_t WS_XN = WS_H + 65 * MiB;
constexpr size_t WS_U = WS_XN + 33 * MiB;
constexpr size_t WS_FHI = WS_U + 90 * MiB;
constexpr size_t WS_END = WS_FHI + 1 * MiB;
static_assert(WS_END <= 256 * MiB, "ws");

__device__ __forceinline__ void tr_store(bf16* WT, int K, int dstrow0, int k0, LAS float* scr, int lane) {
    asm volatile("s_waitcnt lgkmcnt(0)" ::: "memory");
    const int c = lane & 7;
#pragma unroll
    for (int j = 0; j < 4; ++j) { const int n = (lane >> 3) + 8 * j; const LAS float* s = scr + (8 * c) * 33 + n;
        v4u o; o.x = pk2(s[0 * 33], s[1 * 33]); o.y = pk2(s[2 * 33], s[3 * 33]); o.z = pk2(s[4 * 33], s[5 * 33]); o.w = pk2(s[6 * 33], s[7 * 33]);
        *(v4u*)(WT + (size_t)(dstrow0 + n) * K + k0 + 8 * c) = o; }
    asm volatile("s_waitcnt lgkmcnt(0)" ::: "memory");
}
__device__ __forceinline__ void tr_item(const float* W, int ldw, int srccol0, int k0, const float* gain, float scale, bf16* WT, int K, int dstrow0, LAS float* scr, int lane) {
#pragma unroll 8
    for (int i = 0; i < 32; ++i) { const int kk = 2 * i + (lane >> 5); float v = W[(size_t)(k0 + kk) * ldw + srccol0 + (lane & 31)]; if (gain) v *= gain[k0 + kk]; scr[kk * 33 + (lane & 31)] = v * scale; }
    tr_store(WT, K, dstrow0, k0, scr, lane);
}
struct PrepArgs { const float* in[22]; unsigned char* ws; int layer; int pad; };
constexpr int IT_GU = 22 * 2 * 4 * 16, IT_D = 44 * 32, IT_WIN = 72 * 16, IT_CMP = 16 * 16, IT_WOUT = 16 * 32;
constexpr int IT_TOTAL = 2 * IT_GU + 2 * IT_D + IT_WIN + IT_CMP + IT_WOUT;
__device__ __forceinline__ void prep_item(const PrepArgs& a, int it, LAS float* scr, int lane) {
    const int l = a.layer; unsigned char* ws = a.ws;
    if (it < 2 * IT_GU) {
        const int f = it / IT_GU; int r = it % IT_GU; const int kb = r & 15; r >>= 4; const int nb = r & 3; r >>= 2; const int j = r & 1; const int pn = r >> 1;
        const float* Wg = a.in[f ? 19 : 4] + (size_t)l * D * DFF; const float* Wu = a.in[f ? 20 : 5] + (size_t)l * D * DFF; const float* gain = a.in[f ? 17 : 2] + l * D;
        tr_item(j ? Wu : Wg, DFF, 128 * pn + 32 * nb, 64 * kb, gain, 1.f, (bf16*)(ws + (f ? WS_WGU2 : WS_WGU1)), D, 256 * pn + 128 * j + 32 * nb, scr, lane); return; }
    it -= 2 * IT_GU;
    if (it < 2 * IT_D) {
        const int f = it / IT_D; const int r = it % IT_D; const int kb = r % 44, nb = r / 44;
        tr_item(a.in[f ? 21 : 6] + (size_t)l * DFF * D, D, 32 * nb, 64 * kb, nullptr, 1.f, (bf16*)(ws + (f ? WS_WD2 : WS_WD1)), DFF, 32 * nb, scr, lane); return; }
    it -= 2 * IT_D;
    const float* Win = a.in[9] + (size_t)l * D * DPROJ_SRC; const float* gmix = a.in[7] + l * D;
    if (it < IT_WIN) {
        const int kb = it & 15, nb = it >> 4;
        const int dst = nb < 56 ? 256 + 32 * nb : 2304 + 32 * (nb - 56), src = nb < 56 ? 256 + 32 * nb : 2064 + 32 * (nb - 56);
        const float sc = (dst >= PC_Q && dst < PC_K) ? 0.125f : 1.f;
        tr_item(Win, DPROJ_SRC, src, 64 * kb, gmix, sc, (bf16*)(ws + WS_WIN), D, dst, scr, lane); return; }
    it -= IT_WIN;
    if (it < IT_CMP) {
        const int kb = it & 15, nb = it >> 4; const int k0 = 64 * kb;
        if (nb < 8) {
            const int n = 32 * nb + (lane & 31), g = n >> 6, d = n & 63; const float* P = a.in[10] + (size_t)l * 4 * 64 * 64 + g * 4096 + d; const float sc = a.in[11][l * 256 + n];
            for (int i = 0; i < 32; ++i) { const int kk = 2 * i + (lane >> 5); const float* wrow = Win + (size_t)(k0 + kk) * DPROJ_SRC + 64 * g; float s = 0.f;
#pragma unroll 8
                for (int c = 0; c < 64; ++c) s += wrow[c] * P[c * 64];
                scr[kk * 33 + (lane & 31)] = s * sc * gmix[k0 + kk]; }
            tr_store((bf16*)(ws + WS_WIN), D, 32 * nb, k0, scr, lane);
        } else {
            const int j = 32 * (nb - 8) + (lane & 31); const float* w2 = a.in[13] + (size_t)l * 16 * 256 + j;
            for (int i = 0; i < 32; ++i) { const int kk = 2 * i + (lane >> 5); const float* wrow = Win + (size_t)(k0 + kk) * DPROJ_SRC + 2048; float s = 0.f;
#pragma unroll
                for (int r = 0; r < 16; ++r) s += wrow[r] * w2[r * 256];
                scr[kk * 33 + (lane & 31)] = s * gmix[k0 + kk]; }
            tr_store((bf16*)(ws + WS_WIN), D, PC_GX + 32 * (nb - 8), k0, scr, lane);
        }
        return; }
    it -= IT_CMP;
    { const int kb = it & 15, nb = it >> 4;
      tr_item(a.in[16] + (size_t)l * D * D, D, 32 * nb, 64 * kb, nullptr, 1.f, (bf16*)(ws + WS_WOUT), D, 32 * nb, scr, lane); }
}
__global__ __launch_bounds__(256) void k_prep(PrepArgs a) {
    __shared__ float scr_all[4][64 * 33];
    const int lane = threadIdx.x & 63, wave = threadIdx.x >> 6; LAS float* scr = (LAS float*)scr_all[wave];
    for (int it = blockIdx.x * 4 + wave; it < IT_TOTAL; it += gridDim.x * 4) prep_item(a, it, scr, lane);
}

__global__ __launch_bounds__(256) void k_embed(const float* x, const float* meta, float* h, bf16* xn) {
    const int lane = threadIdx.x & 63; const int m = blockIdx.x * 4 + (threadIdx.x >> 6); if (m >= MPAD) return;
    unsigned long long* o8 = (unsigned long long*)(xn + (size_t)m * D) + lane;
    if (m >= MROWS) {
#pragma unroll
        for (int j = 0; j < 4; ++j) o8[64 * j] = 0ull;
        return; }
    const int b = m / LTOK, t = m % LTOK; const float* src = t < NMETA ? meta + (size_t)t * D : x + ((size_t)b * SEQ + (t - NMETA)) * D;
    f32x4 v[4]; float s = 0.f;
#pragma unroll
    for (int j = 0; j < 4; ++j) { v[j] = ((const f32x4*)src)[64 * j + lane]; s += (v[j].x * v[j].x + v[j].y * v[j].y) + (v[j].z * v[j].z + v[j].w * v[j].w); }
    const float r = 1.0f / sqrtf(wave_sum(s) * (1.f / D) + EPS);
#pragma unroll
    for (int j = 0; j < 4; ++j) { ((f32x4*)(h + (size_t)m * D))[64 * j + lane] = v[j];
        o8[64 * j] = (unsigned long long)pk2(v[j].x * r, v[j].y * r) | ((unsigned long long)pk2(v[j].z * r, v[j].w * r) << 32); }
}
__global__ __launch_bounds__(256) void k_resnorm(const float* f_lo, const float* f_hi, float* h, bf16* xn, const float* gpost, float coef) {
    const int lane = threadIdx.x & 63; const int m = blockIdx.x * 4 + (threadIdx.x >> 6); if (m >= MROWS) return;
    const float* fr = m < 16384 ? f_lo + (size_t)m * D : f_hi + (size_t)(m - 16384) * D;
    f32x4 v[4]; float s = 0.f;
#pragma unroll
    for (int j = 0; j < 4; ++j) { v[j] = ((const f32x4*)fr)[64 * j + lane]; s += (v[j].x * v[j].x + v[j].y * v[j].y) + (v[j].z * v[j].z + v[j].w * v[j].w); }
    const float r = coef / sqrtf(wave_sum(s) * (1.f / D) + EPS); float s2 = 0.f;
#pragma unroll
    for (int j = 0; j < 4; ++j) { const f32x4 g = ((const f32x4*)gpost)[64 * j + lane]; f32x4 hv = ((f32x4*)(h + (size_t)m * D))[64 * j + lane];
        hv = hv + v[j] * r * g; v[j] = hv; ((f32x4*)(h + (size_t)m * D))[64 * j + lane] = hv; s2 += (hv.x * hv.x + hv.y * hv.y) + (hv.z * hv.z + hv.w * hv.w); }
    const float r2 = 1.0f / sqrtf(wave_sum(s2) * (1.f / D) + EPS);
    unsigned long long* o8 = (unsigned long long*)(xn + (size_t)m * D) + lane;
#pragma unroll
    for (int j = 0; j < 4; ++j) o8[64 * j] = (unsigned long long)pk2(v[j].x * r2, v[j].y * r2) | ((unsigned long long)pk2(v[j].z * r2, v[j].w * r2) << 32);
}
__global__ __launch_bounds__(256) void k_mix_local(const bf16* proj, bf16* mixin, const float* convw  ) {
    const int idx = blockIdx.x * 256 + threadIdx.x; const int m = idx >> 9, c = idx & 511; if (m >= MROWS) return;
    const int t = m % LTOK; const bf16* p = proj + (size_t)m * NPROJ; float y;
    if (c < 256) { const int w = 2 << (c >> 6); const int cnt = (t + 1) < w ? (t + 1) : w; float s = 0.f;
        for (int i = 0; i < cnt; ++i) s += bf2f(p[PC_POOL + c - (long)i * NPROJ]);
        y = s / (float)cnt - bf2f(p[PC_POOL + c]);
    } else { const int cc = c - 256; float z[3];
#pragma unroll
        for (int i = 0; i < 3; ++i) { const int tt = t - 2 + i; z[i] = tt >= 0 ? bf2f(p[PC_CC + cc - (long)(2 - i) * NPROJ]) * bf2f(p[PC_CU + cc - (long)(2 - i) * NPROJ]) : 0.f; }
        y = bf2f(p[PC_CB + cc]) * (convw[cc] * z[0] + convw[256 + cc] * z[1] + convw[512 + cc] * z[2]); }
    mixin[(size_t)m * D + c] = (bf16)f2bf(y);
}
__global__ __launch_bounds__(128) void k_gla_rec(const bf16* proj, bf16* mixin, const float* b2  , const float* normg  ) {
    const int b = blockIdx.x >> 2, h = blockIdx.x & 3, e = threadIdx.x;
    __shared__ float sq[16][64], sk[16][64], sa[16][64], so[16][128], sr[16];
    float S[64];
#pragma unroll
    for (int d = 0; d < 64; ++d) S[d] = 0.f;
    const float ng = normg[h * 128 + e];
    for (int t0 = 0; t0 < LTOK; t0 += 16) {
        for (int i = e; i < 16 * 64; i += 128) { const int tt = i >> 6, d = i & 63; const bf16* p = proj + (size_t)(b * LTOK + t0 + tt) * NPROJ + h * 64 + d;
            sq[tt][d] = bf2f(p[PC_Q]); sk[tt][d] = bf2f(p[PC_K]);
            const float gx = bf2f(p[PC_GX]) + b2[h * 64 + d];
            const float ls = -(fmaxf(-gx, 0.f) + log1pf(expf(-fabsf(gx))));
            sa[tt][d] = expf(ls * (1.f / 16.f)); }
        __syncthreads();
        for (int tt = 0; tt < 16; ++tt) { const float vv = bf2f(proj[(size_t)(b * LTOK + t0 + tt) * NPROJ + PC_V + h * 128 + e]); float o = 0.f;
#pragma unroll
            for (int d = 0; d < 64; ++d) { S[d] = sa[tt][d] * S[d] + sk[tt][d] * vv; o += sq[tt][d] * S[d]; }
            so[tt][e] = o; }
        __syncthreads();
        if (e < 16) { float ss = 0.f; for (int i = 0; i < 128; ++i) ss += so[e][i] * so[e][i]; sr[e] = 1.0f / sqrtf(ss * (1.f / 128.f) + EPS); }
        __syncthreads();
        for (int tt = 0; tt < 16; ++tt) { const size_t m = (size_t)(b * LTOK + t0 + tt); const float g = bf2f(proj[m * NPROJ + PC_GO + h * 128 + e]);
            const float sg = g / (1.0f + expf(-g)); mixin[m * D + 512 + h * 128 + e] = (bf16)f2bf(so[tt][e] * sr[tt] * ng * sg); }
        __syncthreads();
    }
}
__global__ __launch_bounds__(256) void k_copy_out(const float* h, float* out) {
    const size_t i = (size_t)blockIdx.x * 256 + threadIdx.x;
    const size_t row = i / (D / 4), c4 = i % (D / 4); const size_t b = row / SEQ, t = row % SEQ;
    ((f32x4*)out)[i] = ((const f32x4*)h)[(b * LTOK + NMETA + t) * (D / 4) + c4];
}
template <class Epi> __global__ __launch_bounds__(512, 2) void k_gemm(pg8::Gemm g, Epi E) {
    extern __shared__ __attribute__((aligned(16))) unsigned char lds[];
    pg8::StaticOrder S; S.init(g.M, g.N, (int)gridDim.x, (int)blockIdx.x);
    pg8::gemm_phase<Epi, pg8::StaticOrder, true, true>((PG8_LAS unsigned char*)lds, g, S, E);
}
template <class Epi> static void launch_gemm(const bf16* A, const bf16* Bt, int N, int K, const Epi& E, hipStream_t st) {
    static bool attr = false; if (!attr) { (void)hipFuncSetAttribute((const void*)k_gemm<Epi>, hipFuncAttributeMaxDynamicSharedMemorySize, pg8::STAGE_BYTES); attr = true; }
    pg8::Gemm g{A, Bt, MPAD, N, K, 0};
    hipLaunchKernelGGL((k_gemm<Epi>), dim3(256), dim3(512), pg8::STAGE_BYTES, st, g, E);
}
extern "C" void kernel_launch(void* const* d_in, const int* in_sizes, int n_in, void* d_out, int out_size, void* d_ws, size_t ws_size, hipStream_t stream) {
    if (n_in != 22 || ws_size < WS_END) { fprintf(stderr, "kernel_launch: unexpected n_in %d / ws %zu\n", n_in, ws_size); return; }
    unsigned char* ws = (unsigned char*)d_ws; const float* const* in = (const float* const*)d_in;
    float* h = (float*)(ws + WS_H); bf16* xn = (bf16*)(ws + WS_XN); bf16* ub = (bf16*)(ws + WS_U); float* fhi = (float*)(ws + WS_FHI); float* flo = (float*)d_out;
    hipLaunchKernelGGL(k_embed, dim3(MPAD / 4), dim3(256), 0, stream, in[0], in[1], h, xn);
    for (int l = 0; l < DEPTH; ++l) {
        PrepArgs pa{}; for (int i = 0; i < 22; ++i) pa.in[i] = in[i]; pa.ws = ws; pa.layer = l;
        hipLaunchKernelGGL(k_prep, dim3(1024), dim3(256), 0, stream, pa);
        pg8::EpiF32S Ef{flo, fhi, D, 16384};
        launch_gemm(xn, (const bf16*)(ws + WS_WGU1), NGU, D, pg8::EpiSwiGLU{ub, DFF, 0}, stream);
        launch_gemm(ub, (const bf16*)(ws + WS_WD1), D, DFF, Ef, stream);
        hipLaunchKernelGGL(k_resnorm, dim3((MROWS + 3) / 4), dim3(256), 0, stream, flo, fhi, h, xn, in[3] + l * D, 0.5f);
        launch_gemm(xn, (const bf16*)(ws + WS_WIN), NPROJ, D, pg8::EpiBf16{ub, NPROJ, 0}, stream);
        hipLaunchKernelGGL(k_mix_local, dim3(MROWS * 2), dim3(256), 0, stream, ub, xn, in[12] + l * 3 * 256);
        hipLaunchKernelGGL(k_gla_rec, dim3(32), dim3(128), 0, stream, ub, xn, in[14] + l * 256, in[15] + l * 512);
        launch_gemm(xn, (const bf16*)(ws + WS_WOUT), D, D, Ef, stream);
        hipLaunchKernelGGL(k_resnorm, dim3((MROWS + 3) / 4), dim3(256), 0, stream, flo, fhi, h, xn, in[8] + l * D, 1.0f);
        launch_gemm(xn, (const bf16*)(ws + WS_WGU2), NGU, D, pg8::EpiSwiGLU{ub, DFF, 0}, stream);
        launch_gemm(ub, (const bf16*)(ws + WS_WD2), D, DFF, Ef, stream);
        hipLaunchKernelGGL(k_resnorm, dim3((MROWS + 3) / 4), dim3(256), 0, stream, flo, fhi, h, xn, in[18] + l * D, 0.5f);
    }
    hipLaunchKernelGGL(k_copy_out, dim3(BATCH * SEQ * (D / 4) / 256), dim3(256), 0, stream, h, (float*)d_out);
}
```

```cpp
#include <hip/hip_runtime.h>
#include <cstdio>
#include <cstdint>
namespace pg8 {
#define PG8_LAS __attribute__((address_space(3)))
typedef unsigned short bf16_t;
typedef short bf16x8 __attribute__((ext_vector_type(8)));
typedef float f32x4 __attribute__((ext_vector_type(4)));
typedef unsigned u32x4 __attribute__((ext_vector_type(4)));
constexpr int BM = 256, BK = 64, HALF = 128, HTB = HALF * BK * 2  , STAGE_BYTES = 8 * HTB, NXCD = 8, WGM = 8;

__host__ __device__ __forceinline__ int lds_byte(int r, int c) { const int st = (r >> 4) * 2 + (c >> 5), rr = r & 15, cc = c & 31, ob = rr * 64 + cc * 2; return st * 1024 + (ob ^ (((ob >> 9) & 1) << 5)); }
__host__ __device__ __forceinline__ void stage_rc(int b, int& R, int& C) { const int st = b / 1024, sb = b % 1024, swz = sb ^ (((sb >> 9) & 1) << 5); R = (st >> 1) * 16 + swz / 64; C = (st & 1) * 32 + (swz % 64) / 2; }
__host__ __device__ __forceinline__ int perm32(int rho) { const int n = rho >> 4, i = rho & 15; return 8 * (i >> 2) + 4 * n + (i & 3); }

struct Unit { int pm, pn; };
struct Gemm { const bf16_t* A; const bf16_t* Bt; int M, N, K, pad; };

struct StaticOrder {
    int nM, nN, nwg, G, c;
    __host__ __device__ void init(int M, int N, int G_, int c_) { nM = M / BM; nN = N / BM; nwg = nM * nN; G = G_; c = c_; }
    __host__ __device__ bool next(int i, Unit& u) const {
        const long L = (long)i * G + c; if (L >= nwg) return false;
        int wgid = (int)L; { const int q = nwg / NXCD, r = nwg % NXCD, xcd = wgid % NXCD, off = wgid / NXCD; wgid = (xcd < r ? xcd * (q + 1) : r * (q + 1) + (xcd - r) * q) + off; }
        const int nig = WGM * nN, gid = wgid / nig, fm = gid * WGM, gsz = (nM - fm) < WGM ? (nM - fm) : WGM;
        u.pm = fm + ((wgid % nig) % gsz); u.pn = (wgid % nig) / gsz; return true;
    }
    __device__ __forceinline__ void a_ready(const Unit&) const {}
    __device__ __forceinline__ void done(const Unit&) const {}
};

__device__ __forceinline__ unsigned cvt_pk_bf16(float lo, float hi) { unsigned r; asm volatile("v_cvt_pk_bf16_f32 %0, %1, %2" : "=v"(r) : "v"(lo), "v"(hi)); return r; }
typedef unsigned u32x2 __attribute__((ext_vector_type(2)));
__device__ __forceinline__ float silu_f(float x) { return x * __builtin_amdgcn_rcpf(1.0f + __builtin_amdgcn_exp2f(-1.44269504089f * x)); }
struct EpiBf16 {
    static constexpr bool PERM = true, AFTER_DRAIN = false;
    bf16_t* O; int ldc; int pad;
    __device__ __forceinline__ void operator()(const f32x4 (&acc)[2][2][4][2], const Unit& u, int wr, int wc, int fr, int fq) const {
        const int row0 = u.pm * BM + wr * 64 + fr; const int col0 = u.pn * BM + wc * 32 + 8 * fq;
#pragma unroll
        for (int ai = 0; ai < 2; ++ai)
#pragma unroll
            for (int m = 0; m < 4; ++m) { bf16_t* rowp = O + (size_t)(row0 + ai * HALF + m * 16) * ldc + col0;
#pragma unroll
                for (int bj = 0; bj < 2; ++bj) { const f32x4 v0 = acc[ai][bj][m][0], v1 = acc[ai][bj][m][1];
                    u32x4 w; w.x = cvt_pk_bf16(v0[0], v0[1]); w.y = cvt_pk_bf16(v0[2], v0[3]); w.z = cvt_pk_bf16(v1[0], v1[1]); w.w = cvt_pk_bf16(v1[2], v1[3]);
                    *(u32x4*)(rowp + bj * HALF) = w; } }
    }
};
struct EpiSwiGLU {
    static constexpr bool PERM = true, AFTER_DRAIN = false;
    bf16_t* O; int ldc; int pad;
    __device__ __forceinline__ void operator()(const f32x4 (&acc)[2][2][4][2], const Unit& u, int wr, int wc, int fr, int fq) const {
        const int row0 = u.pm * BM + wr * 64 + fr; const int col0 = u.pn * HALF + wc * 32 + 8 * fq;
#pragma unroll
        for (int ai = 0; ai < 2; ++ai)
#pragma unroll
            for (int m = 0; m < 4; ++m) { bf16_t* rowp = O + (size_t)(row0 + ai * HALF + m * 16) * ldc + col0;
                const f32x4 g0 = acc[ai][0][m][0], g1 = acc[ai][0][m][1], u0 = acc[ai][1][m][0], u1 = acc[ai][1][m][1];
                u32x4 w; w.x = cvt_pk_bf16(silu_f(g0[0]) * u0[0], silu_f(g0[1]) * u0[1]); w.y = cvt_pk_bf16(silu_f(g0[2]) * u0[2], silu_f(g0[3]) * u0[3]);
                w.z = cvt_pk_bf16(silu_f(g1[0]) * u1[0], silu_f(g1[1]) * u1[1]); w.w = cvt_pk_bf16(silu_f(g1[2]) * u1[2], silu_f(g1[3]) * u1[3]);
                *(u32x4*)rowp = w; }
    }
};
struct EpiF32S {
    static constexpr bool PERM = false, AFTER_DRAIN = false;
    float* C_lo; float* C_hi; int ldc; int split_row;
    __device__ __forceinline__ void operator()(const f32x4 (&acc)[2][2][4][2], const Unit& u, int wr, int wc, int fr, int fq) const {
        const int row0 = u.pm * BM + wr * 64 + fr, col0 = u.pn * BM + wc * 32 + 4 * fq;
        float* base = (u.pm * BM < split_row) ? C_lo + (size_t)row0 * ldc : C_hi + (size_t)(row0 - split_row) * ldc;
#pragma unroll
        for (int ai = 0; ai < 2; ++ai)
#pragma unroll
            for (int m = 0; m < 4; ++m) { float* rowp = base + (size_t)(ai * HALF + m * 16) * ldc + col0;
#pragma unroll
                for (int bj = 0; bj < 2; ++bj)
#pragma unroll
                    for (int n = 0; n < 2; ++n) *(f32x4*)(rowp + bj * HALF + n * 16) = acc[ai][bj][m][n]; }
    }
};
template <class Epi, class Sched, bool ALIGN_EPI = false, bool SP2 = false>
__device__ __forceinline__ void gemm_phase(PG8_LAS unsigned char* lds, const Gemm g, const Sched& S, const Epi& E) {
    int tid_ = threadIdx.x; asm volatile("" : "+v"(tid_));
    const int tid = tid_, wid = __builtin_amdgcn_readfirstlane(tid >> 6), lane = tid & 63, wr = wid >> 2, wc = wid & 3, fr = lane & 15, fq = lane >> 4;
    const int K = g.K, nt = K / BK;
    unsigned voffA[2], voffB[2];
#pragma unroll
    for (int i = 0; i < 2; ++i) { int R, C; stage_rc(tid * 16 + i * 8192, R, C); const int Rb = Epi::PERM ? ((R & ~31) + perm32(R & 31)) : R;
        voffA[i] = (unsigned)(R * K + C) * 2u; voffB[i] = (unsigned)(Rb * K + C) * 2u; }
    const size_t kstep = (size_t)(BK * 2);
    const size_t hstep = (size_t)HALF * K * 2;
    const size_t tstep = 2 * hstep;
    const unsigned ldsw = (unsigned)wid * 1024u;
    const int aoff = lds_byte(wr * 64 + fr, fq * 8), boff = lds_byte(wc * 32 + fr, fq * 8);
#define PG8_SA(b, h) (((b) * 2 + (h)) * HTB)
#define PG8_SB(b, h) ((4 + (b) * 2 + (h)) * HTB)
#define PG8_STAGE(bufoff, gbase, voff) do { _Pragma("unroll") for (int _i = 0; _i < 2; ++_i) \
        __builtin_amdgcn_global_load_lds((const unsigned*)((const char*)(gbase) + (voff)[_i]), (PG8_LAS unsigned*)(lds + (bufoff) + ldsw + _i * 8192), 16, 0, 0); } while (0)
#define PG8_LDA(dst, b, h) do { _Pragma("unroll") for (int m = 0; m < 4; ++m) _Pragma("unroll") for (int k = 0; k < 2; ++k) dst[m][k] = *(const PG8_LAS bf16x8*)(lds + PG8_SA(b, h) + aoff + m * 2048 + k * 1024); } while (0)
#define PG8_LDB(dst, b, h) do { _Pragma("unroll") for (int n = 0; n < 2; ++n) _Pragma("unroll") for (int k = 0; k < 2; ++k) dst[n][k] = *(const PG8_LAS bf16x8*)(lds + PG8_SB(b, h) + boff + n * 2048 + k * 1024); } while (0)
#define PG8_MMA(ai, bj, At, Bt) do { __builtin_amdgcn_s_setprio(1); _Pragma("unroll") for (int m = 0; m < 4; ++m) _Pragma("unroll") for (int n = 0; n < 2; ++n) _Pragma("unroll") for (int k = 0; k < 2; ++k) \
        acc[ai][bj][m][n] = __builtin_amdgcn_mfma_f32_16x16x32_bf16(Bt[n][k], At[m][k], acc[ai][bj][m][n], 0, 0, 0); __builtin_amdgcn_s_setprio(0); } while (0)
#define PG8_WAIT_V(n) asm volatile("s_waitcnt vmcnt(" #n ")" ::: "memory")
#define PG8_WAIT_L(n) asm volatile("s_waitcnt lgkmcnt(" #n ")" ::: "memory")
#define PG8_BAR __builtin_amdgcn_s_barrier()
#define PG8_SCHED __builtin_amdgcn_sched_barrier(0)
    Unit cur, nxt; int ui = 0;
    if (!S.next(0, cur)) return;
    f32x4 acc[2][2][4][2];
#pragma unroll
    for (int a = 0; a < 2; ++a)
#pragma unroll
        for (int b = 0; b < 2; ++b)
#pragma unroll
            for (int m = 0; m < 4; ++m)
#pragma unroll
                for (int n = 0; n < 2; ++n) acc[a][b][m][n] = (f32x4){0.f, 0.f, 0.f, 0.f};
    bf16x8 At[4][2], B0[2][2], B1[2][2];
    const char* cA = (const char*)g.A + (size_t)cur.pm * tstep; const char* cB = (const char*)g.Bt + (size_t)cur.pn * tstep;
    S.a_ready(cur);
    if constexpr (SP2) {
        PG8_STAGE(PG8_SB(0, 0), cB, voffB); PG8_STAGE(PG8_SB(0, 1), cB + hstep, voffB); PG8_STAGE(PG8_SA(0, 0), cA, voffA); PG8_STAGE(PG8_SA(0, 1), cA + hstep, voffA);
        if (wr == 1) PG8_BAR;
        PG8_WAIT_V(2); PG8_BAR;
        PG8_STAGE(PG8_SB(1, 0), cB + kstep, voffB); PG8_STAGE(PG8_SA(1, 0), cA + kstep, voffA); PG8_STAGE(PG8_SB(1, 1), cB + hstep + kstep, voffB);
        PG8_WAIT_V(6); PG8_BAR;
    } else {
        PG8_STAGE(PG8_SB(0, 0), cB, voffB); PG8_STAGE(PG8_SA(0, 0), cA, voffA); PG8_STAGE(PG8_SB(0, 1), cB + hstep, voffB); PG8_STAGE(PG8_SA(0, 1), cA + hstep, voffA);
        if (wr == 1) PG8_BAR;
        PG8_WAIT_V(4); PG8_BAR;
        PG8_STAGE(PG8_SB(1, 0), cB + kstep, voffB); PG8_STAGE(PG8_SA(1, 0), cA + kstep, voffA); PG8_STAGE(PG8_SB(1, 1), cB + hstep + kstep, voffB);
        PG8_WAIT_V(6); PG8_BAR;
    }
    for (;;) {
        const bool has_next = S.next(ui + 1, nxt);
        const char* nA = has_next ? (const char*)g.A + (size_t)nxt.pm * tstep : cA; const char* nB = has_next ? (const char*)g.Bt + (size_t)nxt.pn * tstep : cB;
        for (int t = 0; t < nt; t += 2) {
            const bool last = (t == nt - 2);
            const char* a1 = cA + (size_t)(t + 1) * kstep;
            const char* a2 = last ? nA : cA + (size_t)(t + 2) * kstep; const char* b2 = last ? nB : cB + (size_t)(t + 2) * kstep;
            const char* a3 = a2 + kstep; const char* b3 = b2 + kstep;
            if (last && has_next) S.a_ready(nxt);
            if constexpr (SP2) {
            PG8_LDB(B0, 0, 0); PG8_LDB(B1, 0, 1); PG8_SCHED; PG8_LDA(At, 0, 0); PG8_STAGE(PG8_SA(1, 1), a1 + hstep, voffA);
            PG8_WAIT_V(8); PG8_WAIT_L(0); PG8_BAR; PG8_MMA(0, 0, At, B0); PG8_MMA(0, 1, At, B1); PG8_BAR; PG8_SCHED;
            PG8_LDA(At, 0, 1); PG8_STAGE(PG8_SB(0, 0), b2, voffB); PG8_STAGE(PG8_SB(0, 1), b2 + hstep, voffB); PG8_STAGE(PG8_SA(0, 0), a2, voffA);
            PG8_WAIT_V(8); PG8_WAIT_L(0); PG8_BAR; PG8_MMA(1, 0, At, B0); PG8_MMA(1, 1, At, B1); PG8_BAR; PG8_SCHED;
            PG8_LDB(B0, 1, 0); PG8_LDB(B1, 1, 1); PG8_SCHED; PG8_LDA(At, 1, 0); PG8_STAGE(PG8_SA(0, 1), a2 + hstep, voffA);
            PG8_WAIT_V(8); PG8_WAIT_L(0); PG8_BAR; PG8_MMA(0, 0, At, B0); PG8_MMA(0, 1, At, B1); PG8_BAR; PG8_SCHED;
            PG8_LDA(At, 1, 1); PG8_STAGE(PG8_SB(1, 0), b3, voffB); PG8_STAGE(PG8_SB(1, 1), b3 + hstep, voffB); PG8_STAGE(PG8_SA(1, 0), a3, voffA);
            PG8_WAIT_V(8); PG8_WAIT_L(0); PG8_BAR; PG8_MMA(1, 0, At, B0); PG8_MMA(1, 1, At, B1); PG8_BAR; PG8_SCHED;
            } else {
            PG8_LDB(B0, 0, 0); PG8_SCHED; PG8_LDA(At, 0, 0); PG8_STAGE(PG8_SA(1, 1), a1 + hstep, voffA);
            PG8_WAIT_L(8); PG8_BAR; PG8_WAIT_L(0); PG8_MMA(0, 0, At, B0); PG8_BAR; PG8_SCHED;
            PG8_LDB(B1, 0, 1); PG8_STAGE(PG8_SB(0, 0), b2, voffB);
            PG8_BAR; PG8_WAIT_L(0); PG8_MMA(0, 1, At, B1); PG8_BAR;
            PG8_LDA(At, 0, 1); PG8_STAGE(PG8_SA(0, 0), a2, voffA);
            PG8_BAR; PG8_WAIT_L(0); PG8_MMA(1, 0, At, B0); PG8_BAR; PG8_SCHED;
            PG8_STAGE(PG8_SB(0, 1), b2 + hstep, voffB);
            PG8_WAIT_V(6); PG8_BAR; PG8_MMA(1, 1, At, B1); PG8_BAR;
            PG8_LDB(B0, 1, 0); PG8_SCHED; PG8_LDA(At, 1, 0); PG8_STAGE(PG8_SA(0, 1), a2 + hstep, voffA);
            PG8_WAIT_L(8); PG8_BAR; PG8_WAIT_L(0); PG8_MMA(0, 0, At, B0); PG8_BAR; PG8_SCHED;
            PG8_LDB(B1, 1, 1); PG8_STAGE(PG8_SB(1, 0), b3, voffB);
            PG8_BAR; PG8_WAIT_L(0); PG8_MMA(0, 1, At, B1); PG8_BAR;
            PG8_LDA(At, 1, 1); PG8_STAGE(PG8_SA(1, 0), a3, voffA);
            PG8_BAR; PG8_WAIT_L(0); PG8_MMA(1, 0, At, B0); PG8_BAR; PG8_SCHED;
            PG8_STAGE(PG8_SB(1, 1), b3 + hstep, voffB);
            PG8_WAIT_V(6); PG8_BAR; PG8_MMA(1, 1, At, B1); PG8_BAR;
            }
        }
        if constexpr (ALIGN_EPI) { if (wr == 0) PG8_BAR; }
        if constexpr (!Epi::AFTER_DRAIN) { E(acc, cur, wr, wc, fr, fq); S.done(cur); }
        if (!has_next) break;
#pragma unroll
        for (int a = 0; a < 2; ++a)
#pragma unroll
            for (int b = 0; b < 2; ++b)
#pragma unroll
                for (int m = 0; m < 4; ++m)
#pragma unroll
                    for (int n = 0; n < 2; ++n) acc[a][b][m][n] = (f32x4){0.f, 0.f, 0.f, 0.f};
        cur = nxt; cA = nA; cB = nB; ++ui;
        if constexpr (ALIGN_EPI) { if (wr == 1) PG8_BAR; }
    }
    PG8_WAIT_V(0);
    if constexpr (!ALIGN_EPI) { if (wr == 0) PG8_BAR; }
    PG8_BAR;
    if constexpr (Epi::AFTER_DRAIN) { E.fused(acc, cur, wr, wc, fr, fq, lds, wid, lane); S.done(cur); }
#undef PG8_SA
#undef PG8_SB
#undef PG8_STAGE
#undef PG8_LDA
#undef PG8_LDB
#undef PG8_MMA
#undef PG8_WAIT_V
#undef PG8_WAIT_L
#undef PG8_BAR
#undef PG8_SCHED
}
}
constexpr int BATCH = 8, SEQ = 2048, NMETA = 16, LTOK = SEQ + NMETA, D = 1024, DFF = 2816, DEPTH = 2;
constexpr int MROWS = BATCH * LTOK;
constexpr int MPAD = 16640;
constexpr int NGU = 2 * DFF;
constexpr int NPROJ = 2816;
constexpr int DPROJ_SRC = 2576;
constexpr float EPS = 1e-6f;
constexpr int PC_POOL = 0, PC_CB = 256, PC_CC = 512, PC_CU = 768, PC_Q = 1024, PC_K = 1280, PC_V = 1536, PC_GX = 2048, PC_GO = 2304;
#define GAS __attribute__((address_space(1)))
#define LAS __attribute__((address_space(3)))
typedef unsigned short bf16;
typedef unsigned v4u __attribute__((ext_vector_type(4)));
typedef float f32x4 __attribute__((ext_vector_type(4)));
__device__ __forceinline__ unsigned f2bf(float f) { unsigned u = __builtin_bit_cast(unsigned, f); return (u + 0x7fffu + ((u >> 16) & 1u)) >> 16; }
__device__ __forceinline__ unsigned pk2(float lo, float hi) { return f2bf(lo) | (f2bf(hi) << 16); }
__device__ __forceinline__ float bf2f(bf16 b) { return __builtin_bit_cast(float, ((unsigned)b) << 16); }
__device__ __forceinline__ float wave_sum(float v) {
#pragma unroll
    for (int o = 1; o < 64; o <<= 1) v += __shfl_xor(v, o);
    return v;
}
constexpr size_t MiB = 1u << 20;
constexpr size_t SZ_WGU = (size_t)NGU * D * 2, SZ_WD = (size_t)D * DFF * 2, SZ_WIN = (size_t)NPROJ * D * 2, SZ_WOUT = (size_t)D * D * 2;
constexpr size_t WS_CTL = 0, CTL_ZERO_BYTES = 1 * MiB;
constexpr size_t WS_WGU1 = 1 * MiB, WS_WD1 = WS_WGU1 + SZ_WGU, WS_WIN = WS_WD1 + SZ_WD, WS_WOUT = WS_WIN + SZ_WIN, WS_WGU2 = WS_WOUT + SZ_WOUT, WS_WD2 = WS_WGU2 + SZ_WGU, WS_WEND = WS_WD2 + SZ_WD;
static_assert(WS_WEND <= 42 * MiB, "weights");
constexpr size_t WS_H = 42 * MiB;
constexpr size_t WS_XN = WS_H + 65 * MiB;
constexpr size_t WS_U = WS_XN + 33 * MiB;
constexpr size_t WS_FHI = WS_U + 90 * MiB;
constexpr size_t WS_END = WS_FHI + 1 * MiB;
static_assert(WS_END <= 256 * MiB, "ws");

__device__ __forceinline__ void tr_store(bf16* WT, int K, int dstrow0, int k0, LAS float* scr, int lane) {
    asm volatile("s_waitcnt lgkmcnt(0)" ::: "memory");
    const int c = lane & 7;
#pragma unroll
    for (int j = 0; j < 4; ++j) { const int n = (lane >> 3) + 8 * j; const LAS float* s = scr + (8 * c) * 33 + n;
        v4u o; o.x = pk2(s[0 * 33], s[1 * 33]); o.y = pk2(s[2 * 33], s[3 * 33]); o.z = pk2(s[4 * 33], s[5 * 33]); o.w = pk2(s[6 * 33], s[7 * 33]);
        *(v4u*)(WT + (size_t)(dstrow0 + n) * K + k0 + 8 * c) = o; }
    asm volatile("s_waitcnt lgkmcnt(0)" ::: "memory");
}
__device__ __forceinline__ void tr_item(const float* W, int ldw, int srccol0, int k0, const float* gain, float scale, bf16* WT, int K, int dstrow0, LAS float* scr, int lane) {
#pragma unroll 8
    for (int i = 0; i < 32; ++i) { const int kk = 2 * i + (lane >> 5); float v = W[(size_t)(k0 + kk) * ldw + srccol0 + (lane & 31)]; if (gain) v *= gain[k0 + kk]; scr[kk * 33 + (lane & 31)] = v * scale; }
    tr_store(WT, K, dstrow0, k0, scr, lane);
}
constexpr int IT_GU = 22 * 2 * 4 * 16, IT_D = 44 * 32, IT_WIN = 72 * 16, IT_CMP = 16 * 16, IT_WOUT = 16 * 32;
constexpr int IT_TOTAL = 2 * IT_GU + 2 * IT_D + IT_WIN + IT_CMP + IT_WOUT;
template <class ArgsT> __device__ __forceinline__ void prep_item(const ArgsT& a, int l, int it, LAS float* scr, int lane) {
    unsigned char* ws = a.ws;
    if (it < 2 * IT_GU) {
        const int f = it / IT_GU; int r = it % IT_GU; const int kb = r & 15; r >>= 4; const int nb = r & 3; r >>= 2; const int j = r & 1; const int pn = r >> 1;
        const float* Wg = (f ? a.in[19] : a.in[4]) + (size_t)l * D * DFF; const float* Wu = (f ? a.in[20] : a.in[5]) + (size_t)l * D * DFF; const float* gain = (f ? a.in[17] : a.in[2]) + l * D;
        tr_item(j ? Wu : Wg, DFF, 128 * pn + 32 * nb, 64 * kb, gain, 1.f, (bf16*)(ws + (f ? WS_WGU2 : WS_WGU1)), D, 256 * pn + 128 * j + 32 * nb, scr, lane); return; }
    it -= 2 * IT_GU;
    if (it < 2 * IT_D) {
        const int f = it / IT_D; const int r = it % IT_D; const int kb = r % 44, nb = r / 44;
        tr_item((f ? a.in[21] : a.in[6]) + (size_t)l * DFF * D, D, 32 * nb, 64 * kb, nullptr, 1.f, (bf16*)(ws + (f ? WS_WD2 : WS_WD1)), DFF, 32 * nb, scr, lane); return; }
    it -= 2 * IT_D;
    const float* Win = a.in[9] + (size_t)l * D * DPROJ_SRC; const float* gmix = a.in[7] + l * D;
    if (it < IT_WIN) {
        const int kb = it & 15, nb = it >> 4;
        const int dst = nb < 56 ? 256 + 32 * nb : 2304 + 32 * (nb - 56), src = nb < 56 ? 256 + 32 * nb : 2064 + 32 * (nb - 56);
        const float sc = (dst >= PC_Q && dst < PC_K) ? 0.125f : 1.f;
        tr_item(Win, DPROJ_SRC, src, 64 * kb, gmix, sc, (bf16*)(ws + WS_WIN), D, dst, scr, lane); return; }
    it -= IT_WIN;
    if (it < IT_CMP) {
        const int kb = it & 15, nb = it >> 4; const int k0 = 64 * kb;
        if (nb < 8) {
            const int n = 32 * nb + (lane & 31), g = n >> 6, d = n & 63; const float* P = a.in[10] + (size_t)l * 4 * 64 * 64 + g * 4096 + d; const float sc = a.in[11][l * 256 + n];
            for (int i = 0; i < 32; ++i) { const int kk = 2 * i + (lane >> 5); const float* wrow = Win + (size_t)(k0 + kk) * DPROJ_SRC + 64 * g; float s = 0.f;
#pragma unroll 8
                for (int c = 0; c < 64; ++c) s += wrow[c] * P[c * 64];
                scr[kk * 33 + (lane & 31)] = s * sc * gmix[k0 + kk]; }
            tr_store((bf16*)(ws + WS_WIN), D, 32 * nb, k0, scr, lane);
        } else {
            const int j = 32 * (nb - 8) + (lane & 31); const float* w2 = a.in[13] + (size_t)l * 16 * 256 + j;
            for (int i = 0; i < 32; ++i) { const int kk = 2 * i + (lane >> 5); const float* wrow = Win + (size_t)(k0 + kk) * DPROJ_SRC + 2048; float s = 0.f;
#pragma unroll
                for (int r = 0; r < 16; ++r) s += wrow[r] * w2[r * 256];
                scr[kk * 33 + (lane & 31)] = s * gmix[k0 + kk]; }
            tr_store((bf16*)(ws + WS_WIN), D, PC_GX + 32 * (nb - 8), k0, scr, lane);
        }
        return; }
    it -= IT_CMP;
    { const int kb = it & 15, nb = it >> 4;
      tr_item(a.in[16] + (size_t)l * D * D, D, 32 * nb, 64 * kb, nullptr, 1.f, (bf16*)(ws + WS_WOUT), D, 32 * nb, scr, lane); }
}
constexpr int NWAVES = 8;
constexpr int RING_OFF = 0, RING_BYTES = 131072;
constexpr int LDSCTL_OFF = RING_BYTES, MISC_OFF = LDSCTL_OFF + 320;
constexpr int LDS_BYTES = 147456;
constexpr int CW_TMO = 0, CW_CODE = 1, CW_BAR = 4096;
typedef GAS unsigned gu32;
#define RLX_AGENT __ATOMIC_RELAXED, __HIP_MEMORY_SCOPE_AGENT
#define VM_WAIT() asm volatile("s_waitcnt vmcnt(0)" ::: "memory")
#define XB_TMO      128
#define XB_XCNT(j)  (256  + 64 * (j))
#define XB_XSUB(j)  (1280 + 64 * (j))
#define XB_XGEN(j)  (2304 + 64 * (j))
#define XB_TOP      3328
#define XB_TOPGEN   3392
#define XCD_BAR_WORDS 3456
#define XB_SPIN_CAP (1u << 18)

__device__ __forceinline__ unsigned xb_ld(unsigned* p)              { return __hip_atomic_load(p, __ATOMIC_RELAXED, __HIP_MEMORY_SCOPE_AGENT); }
__device__ __forceinline__ unsigned xb_add(unsigned* p, unsigned v) { return __hip_atomic_fetch_add(p, v, __ATOMIC_RELAXED, __HIP_MEMORY_SCOPE_AGENT); }
__device__ __forceinline__ unsigned xb_xcc_id() { return (unsigned)__builtin_amdgcn_s_getreg((3 << 11) | 20) & 0xFu; }
#define XB_SPIN(cond, bar) do { unsigned _sp = 0; while (cond) { __builtin_amdgcn_s_sleep(1); \
    if ((++_sp & 255u) == 0u) { if (xb_ld(&(bar)[XB_TMO])) break; if (_sp > XB_SPIN_CAP) { atomicAdd(&(bar)[XB_TMO], 1u); break; } } } } while (0)

struct XcdBarrier {
    unsigned* bar; unsigned x;
    volatile LAS unsigned* st;
};

__device__ __forceinline__ XcdBarrier xcd_barrier_post(unsigned* bar, volatile LAS unsigned* st) {
    XcdBarrier b; b.bar = bar; b.x = xb_xcc_id(); b.st = st;
    if (threadIdx.x == 0) (void)xb_add(&bar[XB_XCNT(b.x)], 1u);
    return b;
}
__device__ __forceinline__ void xcd_barrier_complete(unsigned* bar, unsigned x, unsigned& nloc, unsigned& nx) {
    const unsigned G = gridDim.x * gridDim.y * gridDim.z;
    unsigned sum, cnt, mine, sp = 0u;
    for (;;) {
        sum = 0u; cnt = 0u; mine = 0u;
#pragma unroll
        for (unsigned j = 0; j < 16; ++j) { const unsigned c = xb_ld(&bar[XB_XCNT(j)]); sum += c; cnt += (c > 0u) ? 1u : 0u; mine = (j == x) ? c : mine; }
        if (sum == G) break;
        __builtin_amdgcn_s_sleep(1);
        if ((++sp & 255u) == 0u) { if (xb_ld(&bar[XB_TMO])) break; if (sp > XB_SPIN_CAP) { atomicAdd(&bar[XB_TMO], 1u); break; } }
    }
    nloc = mine > 0u ? mine : 1u; nx = cnt > 0u ? cnt : 1u;
}

__device__ __forceinline__ void xcd_barrier(const XcdBarrier& b) {
    asm volatile("s_waitcnt vmcnt(0)" ::: "memory");
    __syncthreads();
    if (threadIdx.x == 0) {
        unsigned* bar = b.bar;
        __builtin_amdgcn_s_waitcnt(0);
        unsigned nloc = b.st[0], nx = b.st[1];
        if (nloc == 0u) { xcd_barrier_complete(bar, b.x, nloc, nx); b.st[0] = nloc; b.st[1] = nx; }
        const unsigned old = xb_add(&bar[XB_XSUB(b.x)], 1u);
        const unsigned gen = old / nloc;
        if (old + 1u == (gen + 1u) * nloc) {
            __builtin_amdgcn_fence(__ATOMIC_RELEASE, "agent");
            asm volatile("s_waitcnt vmcnt(0)" ::: "memory");
            const unsigned og = xb_add(&bar[XB_TOP], 1u);
            const unsigned tg = og / nx;
            if (og + 1u == (tg + 1u) * nx) xb_add(&bar[XB_TOPGEN], 1u);
            else XB_SPIN(xb_ld(&bar[XB_TOPGEN]) == tg, bar);
            __builtin_amdgcn_fence(__ATOMIC_ACQUIRE, "agent");
            xb_add(&bar[XB_XGEN(b.x)], 1u);
            asm volatile("s_waitcnt vmcnt(0)" ::: "memory");
        } else {
            XB_SPIN(xb_ld(&bar[XB_XGEN(b.x)]) == gen, bar);
            __builtin_amdgcn_fence(__ATOMIC_ACQUIRE, "agent");
            asm volatile("s_waitcnt vmcnt(0)" ::: "memory");
        }
    }
    __syncthreads();
}
struct Ctx { int tid, lane, wave, gw, NGW, bid, G; LAS unsigned char* lds; };
template <class ArgsT> __device__ __forceinline__ void ph_prep(const ArgsT& a, int l, const Ctx& c) {
    LAS float* scr = (LAS float*)(c.lds + RING_OFF + c.wave * 16384);
    for (int it = c.gw; it < IT_TOTAL; it += c.NGW) prep_item(a, l, it, scr, c.lane);
}
__device__ __forceinline__ void ph_embed(const float* x, const float* meta, float* h, bf16* xn, const Ctx& c) {
    for (int m = c.gw; m < MPAD; m += c.NGW) {
        const int lane = c.lane; unsigned long long* o8 = (unsigned long long*)(xn + (size_t)m * D) + lane;
        if (m >= MROWS) {
#pragma unroll
            for (int j = 0; j < 4; ++j) o8[64 * j] = 0ull;
            continue; }
        const int b = m / LTOK, t = m % LTOK; const float* src = t < NMETA ? meta + (size_t)t * D : x + ((size_t)b * SEQ + (t - NMETA)) * D;
        f32x4 v[4]; float s = 0.f;
#pragma unroll
        for (int j = 0; j < 4; ++j) { v[j] = ((const f32x4*)src)[64 * j + lane]; s += (v[j].x * v[j].x + v[j].y * v[j].y) + (v[j].z * v[j].z + v[j].w * v[j].w); }
        const float r = 1.0f / sqrtf(wave_sum(s) * (1.f / D) + EPS);
#pragma unroll
        for (int j = 0; j < 4; ++j) { ((f32x4*)(h + (size_t)m * D))[64 * j + lane] = v[j];
            o8[64 * j] = (unsigned long long)pk2(v[j].x * r, v[j].y * r) | ((unsigned long long)pk2(v[j].z * r, v[j].w * r) << 32); }
    }
}
__device__ __forceinline__ void ph_resnorm(const float* f_lo, const float* f_hi, float* h, bf16* xn, const float* gpost, float coef, const Ctx& c) {
    for (int m = c.gw; m < MROWS; m += c.NGW) {
        const int lane = c.lane; const float* fr = m < 16384 ? f_lo + (size_t)m * D : f_hi + (size_t)(m - 16384) * D;
        f32x4 v[4]; float s = 0.f;
#pragma unroll
        for (int j = 0; j < 4; ++j) { v[j] = ((const f32x4*)fr)[64 * j + lane]; s += (v[j].x * v[j].x + v[j].y * v[j].y) + (v[j].z * v[j].z + v[j].w * v[j].w); }
        const float r = coef / sqrtf(wave_sum(s) * (1.f / D) + EPS); float s2 = 0.f;
#pragma unroll
        for (int j = 0; j < 4; ++j) { const f32x4 g = ((const f32x4*)gpost)[64 * j + lane]; f32x4 hv = ((f32x4*)(h + (size_t)m * D))[64 * j + lane];
            hv = hv + v[j] * r * g; v[j] = hv; ((f32x4*)(h + (size_t)m * D))[64 * j + lane] = hv; s2 += (hv.x * hv.x + hv.y * hv.y) + (hv.z * hv.z + hv.w * hv.w); }
        const float r2 = 1.0f / sqrtf(wave_sum(s2) * (1.f / D) + EPS);
        unsigned long long* o8 = (unsigned long long*)(xn + (size_t)m * D) + lane;
#pragma unroll
        for (int j = 0; j < 4; ++j) o8[64 * j] = (unsigned long long)pk2(v[j].x * r2, v[j].y * r2) | ((unsigned long long)pk2(v[j].z * r2, v[j].w * r2) << 32);
    }
}
__device__ __forceinline__ void ph_mix_local(const bf16* proj, bf16* mixin, const float* convw, const Ctx& c) {
    for (int idx = c.bid * 512 + c.tid; idx < MROWS * 512; idx += c.G * 512) {
        const int m = idx >> 9, ch = idx & 511; const int t = m % LTOK; const bf16* p = proj + (size_t)m * NPROJ; float y;
        if (ch < 256) { const int w = 2 << (ch >> 6); const int cnt = (t + 1) < w ? (t + 1) : w; float s = 0.f;
            for (int i = 0; i < cnt; ++i) s += bf2f(p[PC_POOL + ch - (long)i * NPROJ]);
            y = s / (float)cnt - bf2f(p[PC_POOL + ch]);
        } else { const int cc = ch - 256; float z[3];
#pragma unroll
            for (int i = 0; i < 3; ++i) { const int tt = t - 2 + i; z[i] = tt >= 0 ? bf2f(p[PC_CC + cc - (long)(2 - i) * NPROJ]) * bf2f(p[PC_CU + cc - (long)(2 - i) * NPROJ]) : 0.f; }
            y = bf2f(p[PC_CB + cc]) * (convw[cc] * z[0] + convw[256 + cc] * z[1] + convw[512 + cc] * z[2]); }
        mixin[(size_t)m * D + ch] = (bf16)f2bf(y);
    }
}
__device__ __forceinline__ void ph_gla_rec(const bf16* proj, bf16* mixin, const float* b2, const float* normg, const Ctx& c) {
    if (c.bid >= 32) return;
    const int b = c.bid >> 2, h = c.bid & 3, e = c.tid >> 2, dq = c.tid & 3;
    LAS float* sq = (LAS float*)(c.lds + RING_OFF); LAS float* sk = sq + 16 * 64; LAS float* sa = sk + 16 * 64; LAS float* so = sa + 16 * 64; LAS float* sr = so + 16 * 128;
    float S[16];
#pragma unroll
    for (int d = 0; d < 16; ++d) S[d] = 0.f;
    const float ng = normg[h * 128 + e];
    for (int t0 = 0; t0 < LTOK; t0 += 16) {
        for (int i = c.tid; i < 16 * 64; i += 512) { const int tt = i >> 6, d = i & 63; const bf16* p = proj + (size_t)(b * LTOK + t0 + tt) * NPROJ + h * 64 + d;
            sq[i] = bf2f(p[PC_Q]); sk[i] = bf2f(p[PC_K]);
            const float gx = bf2f(p[PC_GX]) + b2[h * 64 + d];
            const float ls = -(fmaxf(-gx, 0.f) + log1pf(expf(-fabsf(gx))));
            sa[i] = expf(ls * (1.f / 16.f)); }
        __syncthreads();
        for (int tt = 0; tt < 16; ++tt) { const float vv = bf2f(proj[(size_t)(b * LTOK + t0 + tt) * NPROJ + PC_V + h * 128 + e]); float o = 0.f;
#pragma unroll
            for (int d = 0; d < 16; ++d) { const int dd = tt * 64 + dq * 16 + d; S[d] = sa[dd] * S[d] + sk[dd] * vv; o += sq[dd] * S[d]; }
            o += __shfl_xor(o, 1); o += __shfl_xor(o, 2);
            if (dq == 0) so[tt * 128 + e] = o; }
        __syncthreads();
        if (c.tid < 16) { float ss = 0.f; for (int i = 0; i < 128; ++i) ss += so[c.tid * 128 + i] * so[c.tid * 128 + i]; sr[c.tid] = 1.0f / sqrtf(ss * (1.f / 128.f) + EPS); }
        __syncthreads();
        for (int i = c.tid; i < 16 * 128; i += 512) { const int tt = i >> 7, ee = i & 127; const size_t m = (size_t)(b * LTOK + t0 + tt); const float g = bf2f(proj[m * NPROJ + PC_GO + h * 128 + ee]);
            const float sg = g / (1.0f + expf(-g)); mixin[m * D + 512 + h * 128 + ee] = (bf16)f2bf(so[i] * sr[tt] * normg[h * 128 + ee] * sg); }
        __syncthreads();
    }
    (void)ng;
}
__device__ __forceinline__ void ph_copy_out(const float* h, float* out, bool poison, const Ctx& c) {
    const float q = __builtin_nanf("");
    for (size_t i = (size_t)c.bid * 512 + c.tid; i < (size_t)BATCH * SEQ * (D / 4); i += (size_t)c.G * 512) {
        const size_t row = i / (D / 4), c4 = i % (D / 4); const size_t b = row / SEQ, t = row % SEQ;
        f32x4 v = ((const f32x4*)h)[(b * LTOK + NMETA + t) * (D / 4) + c4]; if (poison) v = (f32x4){q, q, q, q};
        ((f32x4*)out)[i] = v; }
}
template <class Epi> __device__ __forceinline__ void ph_gemm(const bf16* A, const bf16* Bt, int N, int K, const Epi& E, const Ctx& c) {
    pg8::Gemm g{A, Bt, MPAD, N, K, 0}; pg8::StaticOrder S; S.init(MPAD, N, c.G, c.bid);
    pg8::gemm_phase<Epi, pg8::StaticOrder, true, true>(c.lds + RING_OFF, g, S, E);
}

struct Args { const float* in[22]; float* out; unsigned char* ws; };
__global__ void __launch_bounds__(NWAVES * 64, 2) mk_fwd(Args args) {
    extern __shared__ __attribute__((aligned(16))) unsigned char lds_raw[];
    Ctx c; c.lds = (LAS unsigned char*)lds_raw; c.tid = threadIdx.x; c.lane = c.tid & 63; c.wave = __builtin_amdgcn_readfirstlane(c.tid >> 6);
    c.bid = blockIdx.x; c.G = gridDim.x; c.gw = c.bid * NWAVES + c.wave; c.NGW = c.G * NWAVES;
    unsigned char* ws = args.ws; gu32* ctl = (gu32*)(ws + WS_CTL);
    volatile LAS unsigned* MISC = (volatile LAS unsigned*)(c.lds + MISC_OFF);
    for (int u = c.tid; u < (LDS_BYTES - LDSCTL_OFF) / 4; u += NWAVES * 64) ((LAS unsigned*)(c.lds + LDSCTL_OFF))[u] = 0u;
    __syncthreads();
    XcdBarrier bar = xcd_barrier_post((unsigned*)(ctl + CW_BAR), MISC + 8);
#define GRID_BAR() xcd_barrier(bar)
    float* h = (float*)(ws + WS_H); bf16* xn = (bf16*)(ws + WS_XN); bf16* ub = (bf16*)(ws + WS_U); float* fhi = (float*)(ws + WS_FHI); float* flo = args.out;
    ph_embed(args.in[0], args.in[1], h, xn, c);
    ph_prep(args, 0, c);
    GRID_BAR();
#pragma unroll 1
    for (int ph = 0; ph < 10 * DEPTH; ++ph) {
        const int l = ph / 10, s = ph % 10;
        { int t_ = threadIdx.x; asm volatile("" : "+v"(t_)); c.tid = t_; c.lane = t_ & 63; }
        if (s == 0 || s == 7) ph_gemm(xn, (const bf16*)(ws + (s == 0 ? WS_WGU1 : WS_WGU2)), NGU, D, pg8::EpiSwiGLU{ub, DFF, 0}, c);
        else if (s == 1 || s == 5 || s == 8) { const pg8::EpiF32S Ef{flo, fhi, D, 16384};
            ph_gemm(s == 5 ? xn : ub, (const bf16*)(ws + (s == 1 ? WS_WD1 : s == 5 ? WS_WOUT : WS_WD2)), D, s == 5 ? D : DFF, Ef, c); }
        else if (s == 2 || s == 6 || s == 9) { const float* gp = (s == 2 ? args.in[3] : s == 6 ? args.in[8] : args.in[18]) + l * D;
            ph_resnorm(flo, fhi, h, xn, gp, s == 6 ? 1.0f : 0.5f, c);
            if (s == 9 && l + 1 < DEPTH) ph_prep(args, l + 1, c); }
        else if (s == 3) ph_gemm(xn, (const bf16*)(ws + WS_WIN), NPROJ, D, pg8::EpiBf16{ub, NPROJ, 0}, c);
        else { ph_mix_local(ub, xn, args.in[12] + l * 3 * 256, c); ph_gla_rec(ub, xn, args.in[14] + l * 256, args.in[15] + l * 512, c); }
        GRID_BAR();
    }
    const bool poison = xb_ld((unsigned*)(ctl + CW_BAR) + XB_TMO) != 0u;
    ph_copy_out(h, args.out, poison, c);
}
extern "C" void kernel_launch(void* const* d_in, const int* in_sizes, int n_in, void* d_out, int out_size, void* d_ws, size_t ws_size, hipStream_t stream) {
    static int grid = 0;
    if (grid == 0) {
        if (n_in != 22 || ws_size < WS_END) { fprintf(stderr, "kernel_launch: unexpected n_in %d / ws %zu\n", n_in, ws_size); grid = -1; return; }
        int dev = 0, cus = 0, per_cu = 0;
        if (hipGetDevice(&dev) != hipSuccess || hipDeviceGetAttribute(&cus, hipDeviceAttributeMultiprocessorCount, dev) != hipSuccess) { grid = -1; return; }
        if (hipFuncSetAttribute((const void*)mk_fwd, hipFuncAttributeMaxDynamicSharedMemorySize, LDS_BYTES) != hipSuccess) { fprintf(stderr, "kernel_launch: hipFuncSetAttribute failed\n"); grid = -1; return; }
        if (hipOccupancyMaxActiveBlocksPerMultiprocessor(&per_cu, (const void*)mk_fwd, NWAVES * 64, LDS_BYTES) != hipSuccess || per_cu < 1) { fprintf(stderr, "kernel_launch: occupancy query says %d\n", per_cu); (void)hipGetLastError(); grid = -1; return; }
        grid = cus;
    }
    if (grid < 0) return;
    if (hipMemsetAsync((char*)d_ws + WS_CTL, 0, CTL_ZERO_BYTES, stream) != hipSuccess) return;
    Args a{}; for (int i = 0; i < 22; ++i) a.in[i] = (const float*)d_in[i]; a.out = (float*)d_out; a.ws = (unsigned char*)d_ws;
    hipLaunchKernelGGL(mk_fwd, dim3(grid), dim3(NWAVES * 64), LDS_BYTES, stream, a);
}
```
